# Optimizing an MI355X kernel written in HIP

```python
import jax, jax.numpy as jnp
from jax import lax
import numpy as np

D_MODEL = 1024
BATCH = 16
SEQ = 2048
DEPTH = 1
DEC_BATCH = 32
DEC_SEQ = 1
PAST_LEN = 16384
PAGE_SIZE = 128

H_RET = 8
DK_RET = 64
DV_RET = 64
RET_WIDTH = H_RET * DV_RET
RET_CHUNK = 128
RET_ROPE_BASE = 10000.0
H_ATT = 8
HD_ATT = 64
ATT_WIDTH = H_ATT * HD_ATT
ATT_ROPE_THETA = 500000.0
ROT_DIMS = HD_ATT // 4
DILATIONS = ((128, 1), (512, 4), (2048, 16))
WINDOW_MAX = 2048
Q_BLOCK = 128
MIX_WIDTH = RET_WIDTH + ATT_WIDTH
PROJ_WIDTH = 4 * RET_WIDTH + 3 * ATT_WIDTH
PROJ_SPLITS = (RET_WIDTH, 2 * RET_WIDTH, 3 * RET_WIDTH, 4 * RET_WIDTH,
               4 * RET_WIDTH + ATT_WIDTH, 4 * RET_WIDTH + 2 * ATT_WIDTH)
D_FF = 2816
CONV_W = 3
PLE_DIM = 256
LN_EPS = 1e-5
ALPHA = (2 * DEPTH) ** 0.25
BETA = (8 * DEPTH) ** -0.25

kernel_name = "hymba_retnet_dilated_convffn_step"


def layer_norm(x, g, b):
    xf = x.astype(jnp.float32)
    mu = jnp.mean(xf, axis=-1, keepdims=True)
    var = jnp.mean(jnp.square(xf - mu), axis=-1, keepdims=True)
    return ((xf - mu) * lax.rsqrt(var + LN_EPS)).astype(x.dtype) * g + b


def head_norm(x):
    mu = jnp.mean(x, axis=-1, keepdims=True)
    var = jnp.mean(jnp.square(x - mu), axis=-1, keepdims=True)
    return (x - mu) * lax.rsqrt(var + LN_EPS)


def rotary(x, pos, n_rot, base):
    half = n_rot // 2
    inv = base ** (-jnp.arange(half, dtype=jnp.float32) / half)
    ang = pos.astype(jnp.float32)[:, None] * inv[None, :]
    cos = jnp.cos(ang)[:, None, :]
    sin = jnp.sin(ang)[:, None, :]
    xr = x[..., :n_rot].astype(jnp.float32)
    x1, x2 = xr[..., :half], xr[..., half:]
    rot = jnp.concatenate([x1 * cos - x2 * sin, x2 * cos + x1 * sin], axis=-1).astype(x.dtype)
    return jnp.concatenate([rot, x[..., n_rot:]], axis=-1)


def project(h, w_in, pos):
    B, T, _ = h.shape
    q_r, k_r, v_r, g_r, q_a, k_a, v_a = jnp.split(h @ w_in, PROJ_SPLITS, axis=-1)
    q_r = rotary(q_r.reshape(B, T, H_RET, DK_RET), pos, DK_RET, RET_ROPE_BASE)
    k_r = rotary(k_r.reshape(B, T, H_RET, DK_RET), pos, DK_RET, RET_ROPE_BASE) * (DK_RET ** -0.5)
    v_r = v_r.reshape(B, T, H_RET, DV_RET)
    q_a = rotary(q_a.reshape(B, T, H_ATT, HD_ATT), pos, ROT_DIMS, ATT_ROPE_THETA)
    k_a = rotary(k_a.reshape(B, T, H_ATT, HD_ATT), pos, ROT_DIMS, ATT_ROPE_THETA)
    v_a = v_a.reshape(B, T, H_ATT, HD_ATT)
    return q_r, k_r, v_r, g_r, q_a, k_a, v_a


def _log_gamma():
    return jnp.log(1.0 - 2.0 ** (-5.0 - jnp.arange(H_RET, dtype=jnp.float32)))


def retention_chunk(state, qkv):
    q, k, v = qkv
    C = q.shape[1]
    lg = _log_gamma()
    idx = jnp.arange(C, dtype=jnp.float32)
    rel = idx[:, None] - idx[None, :]
    decay = jnp.where(rel >= 0, jnp.exp(lg[:, None, None] * jnp.maximum(rel, 0.0)), 0.0)
    inner = jnp.einsum('bhij,bjhe->bihe', jnp.einsum('bihd,bjhd->bhij', q, k) * decay, v)
    cross = jnp.einsum('bihd,bhde->bihe', q, state) * jnp.exp(lg[None, :] * (idx[:, None] + 1.0))[None, :, :, None]
    k_dec = k * jnp.exp(lg[None, :] * (C - 1.0 - idx[:, None]))[None, :, :, None]
    new_state = jnp.exp(lg * C)[None, :, None, None] * state + jnp.einsum('bjhd,bjhe->bhde', k_dec, v)
    return new_state, inner + cross


def retention_prompt(q, k, v):
    B, S, H, _ = q.shape
    n = S // RET_CHUNK

    def chunks(t):
        return jnp.moveaxis(t.astype(jnp.float32).reshape(B, n, RET_CHUNK, H, t.shape[-1]), 1, 0)

    s0 = jnp.zeros((B, H, DK_RET, DV_RET), jnp.float32)
    fin, o = lax.scan(retention_chunk, s0, (chunks(q), chunks(k), chunks(v)))
    return jnp.moveaxis(o, 0, 1).reshape(B, S, H, DV_RET), fin


def _masked_softmax_stats(s, valid):
    s = jnp.where(valid, s, -jnp.inf)
    m = jnp.max(s, axis=-1, keepdims=True)
    pr = jnp.exp(s - m)
    den = jnp.sum(pr, axis=-1, keepdims=True)
    return pr / den, (m + jnp.log(den))[..., 0]


def _to_strided(x, d):
    B, S, H, E = x.shape
    return x.reshape(B, S // d, d, H, E).transpose(0, 2, 1, 3, 4).reshape(B * d, S // d, H, E)


def _from_strided(x, B, d):
    L = x.shape[1]
    rest = x.shape[2:]
    x = jnp.moveaxis(x.reshape((B, d, L) + rest), 1, 2)
    return x.reshape((B, L * d) + rest)


def _banded_dilated(q, k, v, span, d):
    B, S, H, E = q.shape
    L = S // d
    nb = -(-L // Q_BLOCK)
    Lp = nb * Q_BLOCK
    qs = jnp.pad(_to_strided(q, d), ((0, 0), (0, Lp - L), (0, 0), (0, 0))).reshape(B * d, nb, Q_BLOCK, H, E)

    def band(t):
        t = jnp.pad(_to_strided(t, d), ((0, 0), (Q_BLOCK, Lp - L), (0, 0), (0, 0)))
        t = t.reshape(B * d, nb + 1, Q_BLOCK, H, E)
        return jnp.concatenate([t[:, :-1], t[:, 1:]], axis=2)

    kw, vw = band(k), band(v)
    s = jnp.einsum('znqhe,znkhe->znhqk', qs, kw, preferred_element_type=jnp.float32) * (E ** -0.5)
    qi = jnp.arange(Q_BLOCK)[:, None]
    ki = jnp.arange(2 * Q_BLOCK)[None, :]
    dist = Q_BLOCK + qi - ki
    kpos = jnp.arange(nb)[:, None, None] * Q_BLOCK + ki[None] - Q_BLOCK
    valid = ((dist >= 0) & (dist <= span))[None] & (kpos >= 0)
    pr, lse = _masked_softmax_stats(s, valid[None, :, None])
    o = jnp.einsum('znhqk,znkhe->znqhe', pr, vw.astype(jnp.float32)).reshape(B * d, Lp, H, E)[:, :L]
    lse = jnp.swapaxes(lse, 2, 3).reshape(B * d, Lp, H)[:, :L]
    return _from_strided(o, B, d), _from_strided(lse, B, d)


def _gathered_dilated(q, k_all, v_all, span, d, n_past):
    E = q.shape[-1]
    T = q.shape[1]
    idx = n_past + jnp.arange(T)[:, None] - d * jnp.arange(span + 1)[None, :]
    valid = idx >= 0
    idc = jnp.clip(idx, 0)
    kg = k_all[:, idc]
    vg = v_all[:, idc]
    s = jnp.einsum('bthe,btjhe->bthj', q, kg, preferred_element_type=jnp.float32) * (E ** -0.5)
    pr, lse = _masked_softmax_stats(s, valid[None, :, None, :])
    return jnp.einsum('bthj,btjhe->bthe', pr, vg.astype(jnp.float32)), lse


def combine_by_denominator(outs, lses):
    w = jax.nn.softmax(jnp.stack(lses, axis=0), axis=0)
    return jnp.einsum('pbth,pbthe->bthe', w, jnp.stack(outs, axis=0))


def dilated_attention_prompt(q, k, v):
    outs, lses = [], []
    for window, dil in DILATIONS:
        o, l = _banded_dilated(q, k, v, window // dil, dil)
        outs.append(o)
        lses.append(l)
    return combine_by_denominator(outs, lses).astype(q.dtype)


def dilated_attention_sample(q, k_new, v_new, k_buf, v_buf):
    n_past = k_buf.shape[1]
    k_all = jnp.concatenate([k_buf.astype(k_new.dtype), k_new], axis=1)
    v_all = jnp.concatenate([v_buf.astype(v_new.dtype), v_new], axis=1)
    outs, lses = [], []
    for window, dil in DILATIONS:
        o, l = _gathered_dilated(q, k_all, v_all, window // dil, dil, n_past)
        outs.append(o)
        lses.append(l)
    return combine_by_denominator(outs, lses).astype(q.dtype)


def merge_heads(ret_o, g_r, att_o, w_out):
    B, T = ret_o.shape[:2]
    r = head_norm(ret_o).reshape(B, T, RET_WIDTH).astype(g_r.dtype) * jax.nn.silu(g_r)
    a = att_o.reshape(B, T, ATT_WIDTH)
    return jnp.concatenate([r, a], axis=-1) @ w_out


def conv_ffn(h, prefix, w_up, conv_w, conv_b, w_down):
    T = h.shape[1]
    u = h @ w_up
    up = jnp.concatenate([prefix.astype(u.dtype), u], axis=1)
    c = conv_b + sum(conv_w[j] * up[:, j:j + T] for j in range(CONV_W))
    a, g = jnp.split(c, 2, axis=-1)
    return (a * jax.nn.gelu(g)) @ w_down, up[:, T:]


def channel_and_embed(h, mix, p, prefix, ln1_g, ln1_b, w_up, conv_w, conv_b, w_down,
                      w_ple_gate, w_ple_proj, ln2_g, ln2_b):
    h1 = layer_norm(ALPHA * h + mix, ln1_g, ln1_b)
    f, conv_state = conv_ffn(h1, prefix, w_up, conv_w, conv_b, w_down)
    e = jax.nn.sigmoid(h1 @ w_ple_gate) * (p @ w_ple_proj)
    return layer_norm(ALPHA * h1 + f + e, ln2_g, ln2_b), conv_state


def setup_inputs(seed: int = 0) -> dict:
    key = jax.random.key(seed)
    ks = jax.random.split(key, 22)
    f32 = jnp.float32
    win_buf = min(WINDOW_MAX, PAST_LEN)
    two_f = 2 * D_FF

    def nrm(k, shape, scale):
        return jax.random.normal(k, shape, f32) * scale

    return {
        'x_prompt': nrm(ks[0], (BATCH, SEQ, D_MODEL), 1.0),
        'x_sample': nrm(ks[1], (DEC_BATCH, DEC_SEQ, D_MODEL), 1.0),
        'cache_k_win': nrm(ks[2], (DEPTH, DEC_BATCH, win_buf, H_ATT, HD_ATT), 1.0),
        'cache_v_win': nrm(ks[3], (DEPTH, DEC_BATCH, win_buf, H_ATT, HD_ATT), 1.0),
        'state_ret': nrm(ks[4], (DEPTH, DEC_BATCH, H_RET, DK_RET, DV_RET), 0.5),
        'state_conv': nrm(ks[5], (DEPTH, DEC_BATCH, CONV_W - 1, two_f), 1.0),
        'p_prompt': nrm(ks[6], (DEPTH, BATCH, SEQ, PLE_DIM), 1.0),
        'p_sample': nrm(ks[7], (DEPTH, DEC_BATCH, DEC_SEQ, PLE_DIM), 1.0),
        'ln_in_g': 1.0 + nrm(ks[8], (D_MODEL,), 0.02),
        'ln_in_b': nrm(ks[9], (D_MODEL,), 0.02),
        'w_in': nrm(ks[10], (DEPTH, D_MODEL, PROJ_WIDTH), D_MODEL ** -0.5),
        'w_out': nrm(ks[11], (DEPTH, MIX_WIDTH, D_MODEL), BETA * MIX_WIDTH ** -0.5),
        'ln1_g': 1.0 + nrm(ks[12], (DEPTH, D_MODEL), 0.02),
        'ln1_b': nrm(ks[13], (DEPTH, D_MODEL), 0.02),
        'w_up': nrm(ks[14], (DEPTH, D_MODEL, two_f), D_MODEL ** -0.5),
        'conv_w': nrm(ks[15], (DEPTH, CONV_W, two_f), CONV_W ** -0.5),
        'conv_b': nrm(ks[16], (DEPTH, two_f), 0.02),
        'w_down': nrm(ks[17], (DEPTH, D_FF, D_MODEL), BETA * D_FF ** -0.5),
        'w_ple_gate': nrm(ks[18], (DEPTH, D_MODEL, D_MODEL), D_MODEL ** -0.5),
        'w_ple_proj': nrm(ks[19], (DEPTH, PLE_DIM, D_MODEL), BETA * PLE_DIM ** -0.5),
        'ln2_g': 1.0 + nrm(ks[20], (DEPTH, D_MODEL), 0.02),
        'ln2_b': nrm(ks[21], (DEPTH, D_MODEL), 0.02),
    }


def reference(x_prompt, x_sample, cache_k_win, cache_v_win, state_ret, state_conv, p_prompt, p_sample,
              ln_in_g, ln_in_b, w_in, w_out, ln1_g, ln1_b, w_up, conv_w, conv_b, w_down,
              w_ple_gate, w_ple_proj, ln2_g, ln2_b):
    B, S, _ = x_prompt.shape
    T = x_sample.shape[1]
    pos_p = jnp.arange(S, dtype=jnp.int32)
    pos_s = PAST_LEN + jnp.arange(T, dtype=jnp.int32)
    keep = min(WINDOW_MAX, S)
    hp = layer_norm(x_prompt, ln_in_g, ln_in_b)
    hs = layer_norm(x_sample, ln_in_g, ln_in_b)
    kp_l, vp_l, rp_l, cp_l, ks_l, vs_l, rs_l, cs_l = [], [], [], [], [], [], [], []
    for i in range(DEPTH):
        q_r, k_r, v_r, g_r, q_a, k_a, v_a = project(hp, w_in[i], pos_p)
        ret_o, ret_fin = retention_prompt(q_r, k_r, v_r)
        att_o = dilated_attention_prompt(q_a, k_a, v_a)
        mix = merge_heads(ret_o, g_r, att_o, w_out[i])
        hp, conv_p = channel_and_embed(hp, mix, p_prompt[i], jnp.zeros((B, CONV_W - 1, 2 * D_FF), hp.dtype),
                                       ln1_g[i], ln1_b[i], w_up[i], conv_w[i], conv_b[i], w_down[i],
                                       w_ple_gate[i], w_ple_proj[i], ln2_g[i], ln2_b[i])
        kp_l.append(k_a[:, S - keep:])
        vp_l.append(v_a[:, S - keep:])
        rp_l.append(ret_fin.astype(state_ret.dtype))
        cp_l.append(conv_p)
        q_r, k_r, v_r, g_r, q_a, k_a, v_a = project(hs, w_in[i], pos_s)
        ret_new, ret_o = retention_chunk(state_ret[i].astype(jnp.float32),
                                         (q_r.astype(jnp.float32), k_r.astype(jnp.float32), v_r.astype(jnp.float32)))
        att_o = dilated_attention_sample(q_a, k_a, v_a, cache_k_win[i], cache_v_win[i])
        mix = merge_heads(ret_o, g_r, att_o, w_out[i])
        hs, conv_s = channel_and_embed(hs, mix, p_sample[i], state_conv[i],
                                       ln1_g[i], ln1_b[i], w_up[i], conv_w[i], conv_b[i], w_down[i],
                                       w_ple_gate[i], w_ple_proj[i], ln2_g[i], ln2_b[i])
        ks_l.append(k_a)
        vs_l.append(v_a)
        rs_l.append(ret_new.astype(state_ret.dtype))
        cs_l.append(conv_s)
    return (hp, hs, jnp.stack(kp_l), jnp.stack(vp_l), jnp.stack(rp_l), jnp.stack(cp_l),
            jnp.stack(ks_l), jnp.stack(vs_l), jnp.stack(rs_l), jnp.stack(cs_l))
```

```cpp
#include <hip/hip_runtime.h>
#include <math.h>

namespace {
constexpr int D_MODEL = 1024, BATCH = 16, SEQ = 2048, DEC_BATCH = 32, PAST_LEN = 16384;
constexpr int H = 8, HD = 64, RETW = 512, ATTW = 512, PROJW = 3584, D_FF = 2816, TWO_F = 5632, PLE = 256, WIN = 2048;
constexpr float LN_EPS = 1e-5f;
constexpr float ALPHA = 1.189207115002721f;
constexpr int C_QR = 0, C_KR = 512, C_VR = 1024, C_GR = 1536, C_QA = 2048, C_KA = 2560, C_VA = 3072;

__device__ __forceinline__ float wave_sum(float v) {
#pragma unroll
    for (int o = 1; o < 64; o <<= 1) v += __shfl_xor(v, o);
    return v;
}
__device__ __forceinline__ float wave_max(float v) {
#pragma unroll
    for (int o = 1; o < 64; o <<= 1) v = fmaxf(v, __shfl_xor(v, o));
    return v;
}

__global__ void __launch_bounds__(256) ln_rows(const float* in0, float a, const float* in1, const float* in2, const float* in3,
                                               const float* g, const float* b, float* out) {
    __shared__ float red[8];
    const size_t row = blockIdx.x; const int tid = threadIdx.x;
    float v[4];
#pragma unroll
    for (int j = 0; j < 4; ++j) {
        const int c = tid + 256 * j; float x = a * in0[row * D_MODEL + c];
        if (in1) x += in1[row * D_MODEL + c];
        if (in2) x += (1.f / (1.f + expf(-in2[row * D_MODEL + c]))) * in3[row * D_MODEL + c];
        v[j] = x;
    }
    float s = wave_sum(v[0] + v[1] + v[2] + v[3]);
    if ((tid & 63) == 0) red[tid >> 6] = s;
    __syncthreads();
    const float mean = (red[0] + red[1] + red[2] + red[3]) * (1.f / D_MODEL);
    float q = 0.f;
#pragma unroll
    for (int j = 0; j < 4; ++j) { v[j] -= mean; q += v[j] * v[j]; }
    q = wave_sum(q);
    if ((tid & 63) == 0) red[4 + (tid >> 6)] = q;
    __syncthreads();
    const float var = (red[4] + red[5] + red[6] + red[7]) * (1.f / D_MODEL);
    const float rstd = 1.f / sqrtf(var + LN_EPS);
#pragma unroll
    for (int j = 0; j < 4; ++j) { const int c = tid + 256 * j; out[row * D_MODEL + c] = v[j] * rstd * g[c] + b[c]; }
}

__global__ void __launch_bounds__(256) sgemm(const float* A, const float* B, float* C, int M, int N, int K) {
    __shared__ float As[16][64 + 1], Bs[16][64];
    const int tid = threadIdx.x, tx = tid & 15, ty = tid >> 4;
    const int m0 = blockIdx.y * 64, n0 = blockIdx.x * 64;
    float acc[4][4] = {};
    for (int k0 = 0; k0 < K; k0 += 16) {
        for (int i = tid; i < 64 * 16; i += 256) { const int r = i >> 4, c = i & 15; As[c][r] = (m0 + r < M) ? A[(size_t)(m0 + r) * K + k0 + c] : 0.f; }
        for (int i = tid; i < 16 * 64; i += 256) { const int r = i >> 6, c = i & 63; Bs[r][c] = B[(size_t)(k0 + r) * N + n0 + c]; }
        __syncthreads();
#pragma unroll
        for (int k = 0; k < 16; ++k) {
            float a[4], b[4];
#pragma unroll
            for (int i = 0; i < 4; ++i) { a[i] = As[k][ty * 4 + i]; b[i] = Bs[k][tx * 4 + i]; }
#pragma unroll
            for (int i = 0; i < 4; ++i)
#pragma unroll
                for (int j = 0; j < 4; ++j) acc[i][j] += a[i] * b[j];
        }
        __syncthreads();
    }
#pragma unroll
    for (int i = 0; i < 4; ++i) { const int r = m0 + ty * 4 + i; if (r < M)
#pragma unroll
        for (int j = 0; j < 4; ++j) C[(size_t)r * N + n0 + tx * 4 + j] = acc[i][j]; }
}

__global__ void rotary_k(float* z, int rows, int pos0, int period, float* kout, float* vout) {
    const int idx = blockIdx.x * blockDim.x + threadIdx.x;
    const int total = rows * H * 32;
    if (idx >= total) return;
    const int i = idx & 31, h = (idx >> 5) & 7, row = idx >> 8;
    const float pos = (float)(pos0 + (row % period));
    float* zr = z + (size_t)row * PROJW;
    {
        const float inv = powf(10000.0f, -(float)i / 32.0f);
        const float ang = pos * inv; const float c = cosf(ang), s = sinf(ang);
        float* q = zr + C_QR + h * 64; float x1 = q[i], x2 = q[i + 32]; q[i] = x1 * c - x2 * s; q[i + 32] = x2 * c + x1 * s;
        float* k = zr + C_KR + h * 64; x1 = k[i]; x2 = k[i + 32]; k[i] = (x1 * c - x2 * s) * 0.125f; k[i + 32] = (x2 * c + x1 * s) * 0.125f;
    }
    if (i < 8) {
        const float inv = powf(500000.0f, -(float)i / 8.0f);
        const float ang = pos * inv; const float c = cosf(ang), s = sinf(ang);
        float* q = zr + C_QA + h * 64; float x1 = q[i], x2 = q[i + 8]; q[i] = x1 * c - x2 * s; q[i + 8] = x2 * c + x1 * s;
        float* k = zr + C_KA + h * 64; x1 = k[i]; x2 = k[i + 8]; k[i] = x1 * c - x2 * s; k[i + 8] = x2 * c + x1 * s;
    }
}
__global__ void copy_kv(const float* z, int rows, float* kout, float* vout) {
    const int idx = blockIdx.x * blockDim.x + threadIdx.x;
    if (idx >= rows * 512) return;
    const int c = idx & 511, row = idx >> 9;
    kout[(size_t)row * 512 + c] = z[(size_t)row * PROJW + C_KA + c];
    vout[(size_t)row * 512 + c] = z[(size_t)row * PROJW + C_VA + c];
}

__global__ void __launch_bounds__(64) retention_k(const float* z, int T, const float* state_in, float* state_out, float* ro) {
    const int h = blockIdx.x & 7, s = blockIdx.x >> 3, e = threadIdx.x;
    const float gamma = 1.0f - exp2f(-5.0f - (float)h);
    float S[64];
#pragma unroll
    for (int d = 0; d < 64; ++d) S[d] = state_in ? state_in[(((size_t)s * 8 + h) * 64 + d) * 64 + e] : 0.f;
    for (int t = 0; t < T; ++t) {
        const float* zr = z + (size_t)(s * T + t) * PROJW;
        const float* q = zr + C_QR + h * 64; const float* k = zr + C_KR + h * 64; const float v = zr[C_VR + h * 64 + e];
        float o = 0.f;
#pragma unroll
        for (int d = 0; d < 64; ++d) { S[d] = gamma * S[d] + k[d] * v; o += q[d] * S[d]; }
        ro[(size_t)(s * T + t) * 512 + h * 64 + e] = o;
    }
#pragma unroll
    for (int d = 0; d < 64; ++d) state_out[(((size_t)s * 8 + h) * 64 + d) * 64 + e] = S[d];
}
__global__ void __launch_bounds__(64) headnorm_gate(const float* ro, const float* z, float* mix) {
    const int h = blockIdx.x & 7; const size_t row = blockIdx.x >> 3; const int e = threadIdx.x;
    const float o = ro[row * 512 + h * 64 + e];
    const float mu = wave_sum(o) * (1.f / 64.f); const float dlt = o - mu; const float var = wave_sum(dlt * dlt) * (1.f / 64.f);
    const float g = z[row * PROJW + C_GR + h * 64 + e];
    mix[row * D_MODEL + h * 64 + e] = dlt * (1.f / sqrtf(var + LN_EPS)) * (g / (1.f + expf(-g)));
}

__global__ void __launch_bounds__(64) attn_k(const float* z, int T, const float* ck, const float* cv, float* mix) {
    const int h = blockIdx.x & 7; const int row = blockIdx.x >> 3; const int lane = threadIdx.x;
    const float* zr = z + (size_t)row * PROJW;
    const float* q = zr + C_QA + h * 64;
    float o_p[3], lse_p[3];
#pragma unroll
    for (int p = 0; p < 3; ++p) {
        const int d = 1 << (2 * p);
        float sc[3]; bool ok[3];
#pragma unroll
        for (int u = 0; u < 3; ++u) {
            const int j = lane + 64 * u; ok[u] = (j <= 128); sc[u] = -INFINITY;
            if (!ok[u]) continue;
            const float* kp;
            if (T > 0) { const int t = row % T; const int idx = t - d * j; if (idx < 0) { ok[u] = false; continue; } kp = z + (size_t)(row - d * j) * PROJW + C_KA + h * 64; }
            else { const int idx = WIN - d * j; kp = (j == 0) ? (zr + C_KA + h * 64) : (ck + ((size_t)row * WIN + idx) * 512 + h * 64); }
            float s = 0.f;
            for (int dd = 0; dd < 64; dd += 4) { const float4 kk = *(const float4*)(kp + dd); s += q[dd] * kk.x + q[dd + 1] * kk.y + q[dd + 2] * kk.z + q[dd + 3] * kk.w; }
            sc[u] = s * 0.125f;
        }
        const float m = wave_max(fmaxf(fmaxf(sc[0], sc[1]), sc[2]));
        float pr[3]; float den = 0.f;
#pragma unroll
        for (int u = 0; u < 3; ++u) { pr[u] = ok[u] ? expf(sc[u] - m) : 0.f; den += pr[u]; }
        den = wave_sum(den);
        float o = 0.f;
        for (int j = 0; j <= 128; ++j) {
            const float pj = __shfl(j < 64 ? pr[0] : (j < 128 ? pr[1] : pr[2]), j & 63);
            if (pj == 0.f) continue;
            const float* vp;
            if (T > 0) vp = z + (size_t)(row - d * j) * PROJW + C_VA + h * 64;
            else { const int idx = WIN - d * j; vp = (j == 0) ? (zr + C_VA + h * 64) : (cv + ((size_t)row * WIN + idx) * 512 + h * 64); }
            o += pj * vp[lane];
        }
        o_p[p] = o / den; lse_p[p] = m + logf(den);
    }
    const float M = fmaxf(fmaxf(lse_p[0], lse_p[1]), lse_p[2]);
    const float w0 = expf(lse_p[0] - M), w1 = expf(lse_p[1] - M), w2 = expf(lse_p[2] - M);
    mix[(size_t)row * D_MODEL + 512 + h * 64 + lane] = (w0 * o_p[0] + w1 * o_p[1] + w2 * o_p[2]) / (w0 + w1 + w2);
}

__global__ void conv_gate(const float* u, int rows, int T, const float* prefix, const float* cw, const float* cb, float* act) {
    const int idx = blockIdx.x * blockDim.x + threadIdx.x;
    if (idx >= rows * D_FF) return;
    const int c = idx % D_FF, row = idx / D_FF;
    float cv[2];
#pragma unroll
    for (int half = 0; half < 2; ++half) {
        const int cc = c + half * D_FF;
        float u0, u1;
        if (T > 0) { const int t = row % T; u0 = (t >= 2) ? u[(size_t)(row - 2) * TWO_F + cc] : 0.f; u1 = (t >= 1) ? u[(size_t)(row - 1) * TWO_F + cc] : 0.f; }
        else { u0 = prefix[((size_t)row * 2 + 0) * TWO_F + cc]; u1 = prefix[((size_t)row * 2 + 1) * TWO_F + cc]; }
        cv[half] = cb[cc] + cw[cc] * u0 + cw[TWO_F + cc] * u1 + cw[2 * TWO_F + cc] * u[(size_t)row * TWO_F + cc];
    }
    const float g = cv[1];
    const float gl = 0.5f * g * (1.f + tanhf(0.7978845608028654f * (g + 0.044715f * g * g * g)));
    act[(size_t)row * D_FF + c] = cv[0] * gl;
}
__global__ void conv_state_prompt(const float* u, int T, float* out  ) {
    const int idx = blockIdx.x * blockDim.x + threadIdx.x;
    if (idx >= 2 * TWO_F) return;
    const int c = idx % TWO_F, r = idx / TWO_F;
    out[idx] = u[(size_t)(T - 2 + r) * TWO_F + c];
}
__global__ void conv_state_sample(const float* u, const float* prefix, float* out  ) {
    const int idx = blockIdx.x * blockDim.x + threadIdx.x;
    if (idx >= DEC_BATCH * 2 * TWO_F) return;
    const int c = idx % TWO_F, r = (idx / TWO_F) & 1, b = idx / (2 * TWO_F);
    out[idx] = (r == 0) ? prefix[((size_t)b * 2 + 1) * TWO_F + c] : u[(size_t)b * TWO_F + c];
}
}

extern "C" void kernel_launch(void* const* d_in, const int* in_sizes, int n_in, void* d_out, int out_size, void* d_ws, size_t ws_size, hipStream_t stream) {
    const float* x_prompt = (const float*)d_in[0]; const float* x_sample = (const float*)d_in[1];
    const float* cache_k = (const float*)d_in[2]; const float* cache_v = (const float*)d_in[3];
    const float* state_ret = (const float*)d_in[4]; const float* state_conv = (const float*)d_in[5];
    const float* p_prompt = (const float*)d_in[6]; const float* p_sample = (const float*)d_in[7];
    const float* ln_in_g = (const float*)d_in[8]; const float* ln_in_b = (const float*)d_in[9];
    const float* w_in = (const float*)d_in[10]; const float* w_out = (const float*)d_in[11];
    const float* ln1_g = (const float*)d_in[12]; const float* ln1_b = (const float*)d_in[13];
    const float* w_up = (const float*)d_in[14]; const float* conv_w = (const float*)d_in[15]; const float* conv_b = (const float*)d_in[16];
    const float* w_down = (const float*)d_in[17]; const float* w_pg = (const float*)d_in[18]; const float* w_pp = (const float*)d_in[19];
    const float* ln2_g = (const float*)d_in[20]; const float* ln2_b = (const float*)d_in[21];
    float* out = (float*)d_out;
    const size_t O_YP = 0, O_YS = O_YP + (size_t)BATCH * SEQ * D_MODEL, O_KP = O_YS + (size_t)DEC_BATCH * D_MODEL, O_VP = O_KP + (size_t)BATCH * SEQ * 512,
                 O_RP = O_VP + (size_t)BATCH * SEQ * 512, O_CP = O_RP + (size_t)BATCH * 8 * 64 * 64, O_KS = O_CP + (size_t)BATCH * 2 * TWO_F,
                 O_VS = O_KS + (size_t)DEC_BATCH * 512, O_RS = O_VS + (size_t)DEC_BATCH * 512, O_CS = O_RS + (size_t)DEC_BATCH * 8 * 64 * 64;
    float* ws = (float*)d_ws; size_t off = 0;
    auto take = [&](size_t n) { float* p = ws + off; off += n; return p; };
    const int R = SEQ;
    float* Hb = take((size_t)R * D_MODEL); float* Z = take((size_t)R * PROJW); float* RO = take((size_t)R * 512); float* MIX = take((size_t)R * D_MODEL);
    float* M1 = take((size_t)R * D_MODEL); float* H1 = take((size_t)R * D_MODEL); float* U = take((size_t)R * TWO_F); float* ACT = take((size_t)R * D_FF);
    float* F = take((size_t)R * D_MODEL); float* GA = take((size_t)R * D_MODEL); float* PR = take((size_t)R * D_MODEL);

    for (int g = 0; g <= BATCH; ++g) {
        const bool smp = (g == BATCH);
        const int rows = smp ? DEC_BATCH : SEQ, T = smp ? 0 : SEQ;
        const float* x = smp ? x_sample : x_prompt + (size_t)g * SEQ * D_MODEL;
        const float* p = smp ? p_sample : p_prompt + (size_t)g * SEQ * PLE;
        float* y = smp ? out + O_YS : out + O_YP + (size_t)g * SEQ * D_MODEL;
        float* ko = smp ? out + O_KS : out + O_KP + (size_t)g * SEQ * 512;
        float* vo = smp ? out + O_VS : out + O_VP + (size_t)g * SEQ * 512;
        const dim3 gm((unsigned)((rows + 63) / 64));
        ln_rows<<<rows, 256, 0, stream>>>(x, 1.f, nullptr, nullptr, nullptr, ln_in_g, ln_in_b, Hb);
        sgemm<<<dim3(PROJW / 64, gm.x), 256, 0, stream>>>(Hb, w_in, Z, rows, PROJW, D_MODEL);
        rotary_k<<<(rows * H * 32 + 255) / 256, 256, 0, stream>>>(Z, rows, smp ? PAST_LEN : 0, smp ? 1 : (1 << 30), ko, vo);
        copy_kv<<<(rows * 512 + 255) / 256, 256, 0, stream>>>(Z, rows, ko, vo);
        if (smp) retention_k<<<DEC_BATCH * 8, 64, 0, stream>>>(Z, 1, state_ret, out + O_RS, RO);
        else retention_k<<<8, 64, 0, stream>>>(Z, SEQ, nullptr, out + O_RP + (size_t)g * 8 * 64 * 64, RO);
        headnorm_gate<<<rows * 8, 64, 0, stream>>>(RO, Z, MIX);
        attn_k<<<rows * 8, 64, 0, stream>>>(Z, T, cache_k, cache_v, MIX);
        sgemm<<<dim3(D_MODEL / 64, gm.x), 256, 0, stream>>>(MIX, w_out, M1, rows, D_MODEL, D_MODEL);
        ln_rows<<<rows, 256, 0, stream>>>(Hb, ALPHA, M1, nullptr, nullptr, ln1_g, ln1_b, H1);
        sgemm<<<dim3(TWO_F / 64, gm.x), 256, 0, stream>>>(H1, w_up, U, rows, TWO_F, D_MODEL);
        conv_gate<<<(rows * D_FF + 255) / 256, 256, 0, stream>>>(U, rows, T, state_conv, conv_w, conv_b, ACT);
        if (smp) conv_state_sample<<<(DEC_BATCH * 2 * TWO_F + 255) / 256, 256, 0, stream>>>(U, state_conv, out + O_CS);
        else conv_state_prompt<<<(2 * TWO_F + 255) / 256, 256, 0, stream>>>(U, SEQ, out + O_CP + (size_t)g * 2 * TWO_F);
        sgemm<<<dim3(D_MODEL / 64, gm.x), 256, 0, stream>>>(ACT, w_down, F, rows, D_MODEL, D_FF);
        sgemm<<<dim3(D_MODEL / 64, gm.x), 256, 0, stream>>>(H1, w_pg, GA, rows, D_MODEL, D_MODEL);
        sgemm<<<dim3(D_MODEL / 64, gm.x), 256, 0, stream>>>(p, w_pp, PR, rows, D_MODEL, PLE);
        ln_rows<<<rows, 256, 0, stream>>>(H1, ALPHA, F, GA, PR, ln2_g, ln2_b, y);
    }
}
```
